# Optimizing an MI355X kernel written in HIP

```python
import math
import jax, jax.numpy as jnp
from jax import lax
import numpy as np

D_MODEL = 1024
BATCH = 2
SEQ = 8192
DEPTH = 4

D_CONV = 256
CONV_WIDTH = 3
D_SSM = 256
SSM_GROUP = 16
N_SSM_GROUPS = D_SSM // SSM_GROUP
SSM_STATE = 64
DT_MIN = 1e-3
DT_MAX = 1e-1
N_Q_HEADS = 8
N_KV_HEADS = 2
HEAD_DIM = 64
D_ATTN = N_Q_HEADS * HEAD_DIM
D_KV = N_KV_HEADS * HEAD_DIM
WINDOW = 128
BLOCK = 128
N_BRANCH = 3
D_FF = 2816
ALPHA = (2 * DEPTH) ** 0.25
BETA = (8 * DEPTH) ** -0.25
LN_EPS = 1e-5
D_IN = 3 * D_CONV + D_SSM + D_ATTN + 2 * D_KV + N_BRANCH * D_MODEL

kernel_name = 'hybrid_gated_conv_s5_swa_macaron_deepnorm'


def layer_norm(x, g, b):
    xf = x.astype(jnp.float32)
    mu = jnp.mean(xf, axis=-1, keepdims=True)
    var = jnp.mean(jnp.square(xf - mu), axis=-1, keepdims=True)
    y = (xf - mu) * lax.rsqrt(var + LN_EPS)
    return (y * g.astype(jnp.float32) + b.astype(jnp.float32)).astype(x.dtype)


def swiglu(x, w_gate, w_up, w_down):
    return (jax.nn.silu(x @ w_gate) * (x @ w_up)) @ w_down


def short_conv_mixer(b_gate, c_gate, h, conv_w, conv_b):
    z = c_gate * h
    kern = conv_w[:, None, :].astype(z.dtype)
    y = lax.conv_general_dilated(z, kern, window_strides=(1,), padding=[(CONV_WIDTH - 1, 0)],
                                 dimension_numbers=('NWC', 'WIO', 'NWC'), feature_group_count=D_CONV)
    return b_gate * (y + conv_b)


def s5_mixer(u, a_re, a_im, log_dt, b_re, b_im, c_re, c_im, d_skip, w_glu):
    f32 = jnp.float32
    bsz, s, _ = u.shape
    uf = u.astype(f32).reshape(bsz, s, N_SSM_GROUPS, SSM_GROUP)
    lr = a_re.astype(f32)
    li = a_im.astype(f32)
    dt = jnp.exp(log_dt.astype(f32))[:, None]
    mag = jnp.exp(lr * dt)
    ang = li * dt
    abar_re = mag * jnp.cos(ang)
    abar_im = mag * jnp.sin(ang)
    nr = abar_re - 1.0
    ni = abar_im
    den = lr * lr + li * li
    coef_re = (nr * lr + ni * li) / den
    coef_im = (ni * lr - nr * li) / den
    br = b_re.astype(f32)
    bi = b_im.astype(f32)
    bbar_re = coef_re[..., None] * br - coef_im[..., None] * bi
    bbar_im = coef_re[..., None] * bi + coef_im[..., None] * br
    bu_re = jnp.einsum('bsgc,gpc->bsgp', uf, bbar_re)
    bu_im = jnp.einsum('bsgc,gpc->bsgp', uf, bbar_im)
    aa_re = jnp.broadcast_to(abar_re, bu_re.shape)
    aa_im = jnp.broadcast_to(abar_im, bu_im.shape)

    def combine(e1, e2):
        a1r, a1i, b1r, b1i = e1
        a2r, a2i, b2r, b2i = e2
        return (a2r * a1r - a2i * a1i,
                a2r * a1i + a2i * a1r,
                a2r * b1r - a2i * b1i + b2r,
                a2r * b1i + a2i * b1r + b2i)

    _, _, xs_re, xs_im = lax.associative_scan(combine, (aa_re, aa_im, bu_re, bu_im), axis=1)
    y = (jnp.einsum('bsgp,gcp->bsgc', xs_re, c_re.astype(f32))
         - jnp.einsum('bsgp,gcp->bsgc', xs_im, c_im.astype(f32)))
    y = y + d_skip.astype(f32).reshape(N_SSM_GROUPS, SSM_GROUP) * uf
    y = jax.nn.gelu(y.reshape(bsz, s, D_SSM))
    y = y * jax.nn.sigmoid(y @ w_glu.astype(f32))
    return y.astype(u.dtype)


def sliding_window_attention(q, k, v, sinks):
    f32 = jnp.float32
    bsz, s, _ = q.shape
    nb = s // BLOCK
    grp = N_Q_HEADS // N_KV_HEADS
    qb = q.astype(f32).reshape(bsz, nb, BLOCK, N_KV_HEADS, grp, HEAD_DIM) * (HEAD_DIM ** -0.5)
    kb = k.astype(f32).reshape(bsz, nb, BLOCK, N_KV_HEADS, HEAD_DIM)
    vb = v.astype(f32).reshape(bsz, nb, BLOCK, N_KV_HEADS, HEAD_DIM)
    pad = ((0, 0), (1, 0), (0, 0), (0, 0), (0, 0))
    kk = jnp.concatenate([jnp.pad(kb, pad)[:, :-1], kb], axis=2)
    vv = jnp.concatenate([jnp.pad(vb, pad)[:, :-1], vb], axis=2)
    scores = jnp.einsum('bnqhgd,bnkhd->bnhgqk', qb, kk)
    qpos = jnp.arange(BLOCK)[:, None] + BLOCK
    kpos = jnp.arange(2 * BLOCK)[None, :]
    diff = qpos - kpos
    band = (diff >= 0) & (diff < WINDOW)
    has_prev = (jnp.arange(nb) > 0)[:, None, None] | (kpos >= BLOCK)[None]
    mask = band[None] & has_prev
    scores = jnp.where(mask[None, :, None, None], scores, -jnp.inf)
    sink = sinks.astype(f32).reshape(N_KV_HEADS, grp)[None, None, :, :, None, None]
    m = jnp.maximum(jnp.max(scores, axis=-1, keepdims=True), sink)
    p = jnp.exp(scores - m)
    probs = p / (jnp.sum(p, axis=-1, keepdims=True) + jnp.exp(sink - m))
    out = jnp.einsum('bnhgqk,bnkhd->bnqhgd', probs, vv)
    return out.reshape(bsz, s, D_ATTN).astype(q.dtype)


def hybrid_mixer(x, w_in, conv_w, conv_b, ssm_a_re, ssm_a_im, ssm_log_dt, ssm_b_re, ssm_b_im,
                 ssm_c_re, ssm_c_im, ssm_d, ssm_w_glu, attn_sinks, w_br_conv, w_br_ssm, w_br_attn, w_out):
    bsz, s, _ = x.shape
    proj = x @ w_in
    widths = [D_CONV, D_CONV, D_CONV, D_SSM, D_ATTN, D_KV, D_KV]
    offs = [int(o) for o in np.cumsum(widths)]
    b_g, c_g, h, u, q, k, v, gates = jnp.split(proj, offs, axis=-1)
    y_conv = short_conv_mixer(b_g, c_g, h, conv_w, conv_b) @ w_br_conv
    y_ssm = s5_mixer(u, ssm_a_re, ssm_a_im, ssm_log_dt, ssm_b_re, ssm_b_im,
                     ssm_c_re, ssm_c_im, ssm_d, ssm_w_glu) @ w_br_ssm
    y_attn = sliding_window_attention(q, k, v, attn_sinks) @ w_br_attn
    g = jax.nn.sigmoid(gates).reshape(bsz, s, N_BRANCH, D_MODEL)
    merged = g[:, :, 0] * y_conv + g[:, :, 1] * y_ssm + g[:, :, 2] * y_attn
    return merged @ w_out


def setup_inputs(seed: int = 0) -> dict:
    key = jax.random.key(seed)
    ks = jax.random.split(key, 32)
    L = DEPTH

    def nrm(k, shape, scale):
        return jax.random.normal(k, shape, jnp.float32) * scale

    def gain(k):
        return 1.0 + nrm(k, (L, D_MODEL), 0.01)

    n_idx = jnp.arange(SSM_STATE, dtype=jnp.float32)
    return {
        'x': nrm(ks[0], (BATCH, SEQ, D_MODEL), 1.0),
        'ffn1_w_gate': nrm(ks[1], (L, D_MODEL, D_FF), D_MODEL ** -0.5),
        'ffn1_w_up': nrm(ks[2], (L, D_MODEL, D_FF), D_MODEL ** -0.5),
        'ffn1_w_down': nrm(ks[3], (L, D_FF, D_MODEL), BETA * D_FF ** -0.5),
        'ln1_g': gain(ks[4]),
        'ln1_b': nrm(ks[5], (L, D_MODEL), 0.01),
        'w_in': nrm(ks[6], (L, D_MODEL, D_IN), D_MODEL ** -0.5),
        'conv_w': nrm(ks[7], (L, CONV_WIDTH, D_CONV), CONV_WIDTH ** -0.5),
        'conv_b': nrm(ks[8], (L, D_CONV), 0.01),
        'ssm_a_re': -0.5 + nrm(ks[9], (L, N_SSM_GROUPS, SSM_STATE), 0.01),
        'ssm_a_im': jnp.pi * n_idx + nrm(ks[10], (L, N_SSM_GROUPS, SSM_STATE), 0.01),
        'ssm_log_dt': jax.random.uniform(ks[11], (L, N_SSM_GROUPS), jnp.float32,
                                         math.log(DT_MIN), math.log(DT_MAX)),
        'ssm_b_re': nrm(ks[12], (L, N_SSM_GROUPS, SSM_STATE, SSM_GROUP), (2 * SSM_GROUP) ** -0.5),
        'ssm_b_im': nrm(ks[13], (L, N_SSM_GROUPS, SSM_STATE, SSM_GROUP), (2 * SSM_GROUP) ** -0.5),
        'ssm_c_re': nrm(ks[14], (L, N_SSM_GROUPS, SSM_GROUP, SSM_STATE), SSM_STATE ** -0.5),
        'ssm_c_im': nrm(ks[15], (L, N_SSM_GROUPS, SSM_GROUP, SSM_STATE), SSM_STATE ** -0.5),
        'ssm_d': nrm(ks[16], (L, D_SSM), 1.0),
        'ssm_w_glu': nrm(ks[17], (L, D_SSM, D_SSM), D_SSM ** -0.5),
        'attn_sinks': nrm(ks[18], (L, N_Q_HEADS), 0.5),
        'w_br_conv': nrm(ks[19], (L, D_CONV, D_MODEL), D_CONV ** -0.5),
        'w_br_ssm': nrm(ks[20], (L, D_SSM, D_MODEL), D_SSM ** -0.5),
        'w_br_attn': nrm(ks[21], (L, D_ATTN, D_MODEL), D_ATTN ** -0.5),
        'w_out': nrm(ks[22], (L, D_MODEL, D_MODEL), BETA * D_MODEL ** -0.5),
        'ln2_g': gain(ks[23]),
        'ln2_b': nrm(ks[24], (L, D_MODEL), 0.01),
        'ffn2_w_gate': nrm(ks[25], (L, D_MODEL, D_FF), D_MODEL ** -0.5),
        'ffn2_w_up': nrm(ks[26], (L, D_MODEL, D_FF), D_MODEL ** -0.5),
        'ffn2_w_down': nrm(ks[27], (L, D_FF, D_MODEL), BETA * D_FF ** -0.5),
        'ln3_g': gain(ks[28]),
        'ln3_b': nrm(ks[29], (L, D_MODEL), 0.01),
    }


def reference(x, ffn1_w_gate, ffn1_w_up, ffn1_w_down, ln1_g, ln1_b, w_in, conv_w, conv_b,
              ssm_a_re, ssm_a_im, ssm_log_dt, ssm_b_re, ssm_b_im, ssm_c_re, ssm_c_im, ssm_d,
              ssm_w_glu, attn_sinks, w_br_conv, w_br_ssm, w_br_attn, w_out, ln2_g, ln2_b,
              ffn2_w_gate, ffn2_w_up, ffn2_w_down, ln3_g, ln3_b):
    for l in range(DEPTH):
        x = layer_norm(ALPHA * x + 0.5 * swiglu(x, ffn1_w_gate[l], ffn1_w_up[l], ffn1_w_down[l]),
                       ln1_g[l], ln1_b[l])
        mix = hybrid_mixer(x, w_in[l], conv_w[l], conv_b[l], ssm_a_re[l], ssm_a_im[l], ssm_log_dt[l],
                           ssm_b_re[l], ssm_b_im[l], ssm_c_re[l], ssm_c_im[l], ssm_d[l], ssm_w_glu[l],
                           attn_sinks[l], w_br_conv[l], w_br_ssm[l], w_br_attn[l], w_out[l])
        x = layer_norm(ALPHA * x + mix, ln2_g[l], ln2_b[l])
        x = layer_norm(ALPHA * x + 0.5 * swiglu(x, ffn2_w_gate[l], ffn2_w_up[l], ffn2_w_down[l]),
                       ln3_g[l], ln3_b[l])
    return x
```

```cpp
#include <hip/hip_runtime.h>
#include <hip/hip_cooperative_groups.h>
#include <cstdio>
#include <cstdint>
namespace cg = cooperative_groups;

#define LAS __attribute__((address_space(3)))
typedef unsigned short bf16_t;
typedef short bf16x8 __attribute__((ext_vector_type(8)));
typedef short s16x4 __attribute__((ext_vector_type(4)));
typedef float f32x4 __attribute__((ext_vector_type(4)));
typedef float f32x2 __attribute__((ext_vector_type(2)));
typedef float f32x16 __attribute__((ext_vector_type(16)));
typedef unsigned u32x4 __attribute__((ext_vector_type(4)));
typedef unsigned u32x2 __attribute__((ext_vector_type(2)));
typedef __bf16 bf16x2_t __attribute__((ext_vector_type(2)));

constexpr int MTOK = 16384, DM = 1024, DFF = 2816, DIN = 4864, SEQ = 8192, NLAYER = 4;
constexpr float ALPHA = 1.681792830507429f;
constexpr float LN_EPS = 1e-5f;
constexpr int LDS_BYTES = 147456;

constexpr size_t MiB = 1u << 20;
constexpr size_t WS_WGU1 = 0, WS_WD1 = 11 * MiB, WS_WGU2 = 17 * MiB, WS_WD2 = 28 * MiB, WS_WIN = 34 * MiB, WS_WBR = 44 * MiB, WS_WOUT = 46 * MiB,
                 WS_WGLU = 48 * MiB, WS_TF = 49 * MiB, WS_E = 59 * MiB, WS_UX = 62 * MiB, WS_YPRE = 72 * MiB, WS_XLOC = 80 * MiB, WS_XB = 84 * MiB,
                 WS_YCAT = 116 * MiB, WS_MERGED = 148 * MiB, WS_UNION = 180 * MiB, WS_END = 340 * MiB;
constexpr size_t UNION_V = 96 * MiB;

__device__ __forceinline__ unsigned pk2(float lo, float hi) { f32x2 v = {lo, hi}; return __builtin_bit_cast(unsigned, __builtin_convertvector(v, bf16x2_t)); }
__device__ __forceinline__ float bf_lo(unsigned u) { return __uint_as_float(u << 16); }
__device__ __forceinline__ float bf_hi(unsigned u) { return __uint_as_float(u & 0xffff0000u); }
__device__ __forceinline__ float fast_sigmoid(float x) { return __builtin_amdgcn_rcpf(1.0f + __expf(-x)); }
__device__ __forceinline__ float wave_sum(float v) {
#pragma unroll
    for (int o = 1; o < 64; o <<= 1) v += __shfl_xor(v, o);
    return v;
}
__device__ __forceinline__ void unpack8(const u32x4 w, float (&f)[8]) {
    f[0] = bf_lo(w.x); f[1] = bf_hi(w.x); f[2] = bf_lo(w.y); f[3] = bf_hi(w.y); f[4] = bf_lo(w.z); f[5] = bf_hi(w.z); f[6] = bf_lo(w.w); f[7] = bf_hi(w.w);
}

__device__ __forceinline__ int opaque_tid() { int t = threadIdx.x; asm volatile("" : "+v"(t)); return t; }
namespace pg8 {
constexpr int BM = 256, BK = 64, HALF = 128, HTB = HALF * BK * 2, STAGE_BYTES = 8 * HTB;
__device__ __forceinline__ int lds_byte(int r, int c) { const int st = (r >> 4) * 2 + (c >> 5), rr = r & 15, cc = c & 31, ob = rr * 64 + cc * 2; return st * 1024 + (ob ^ (((ob >> 9) & 1) << 5)); }
__device__ __forceinline__ void stage_rc(int b, int& R, int& C) { const int st = b / 1024, sb = b % 1024, swz = sb ^ (((sb >> 9) & 1) << 5); R = (st >> 1) * 16 + swz / 64; C = (st & 1) * 32 + (swz % 64) / 2; }
__device__ __forceinline__ int perm32(int rho) { const int n = rho >> 4, i = rho & 15; return 8 * (i >> 2) + 4 * n + (i & 3); }

struct GUnit { const char* A; const char* B; int nt, pm, pn, z, seg; };

struct Sched {
    const char* A; const char* B;
    int nM, nN, nZ, nseg, G, c;
    size_t a_tile, b_tile, a_z, b_z;
    unsigned k0pack, ntpack;
    __device__ __forceinline__ bool next(int i, GUnit& u) const {
        const int sup = i / nseg, seg = i - sup * nseg;
        const int nwg = nM * nN;
        const long L = (long)sup * G + c;
        if (L >= (long)nwg * nZ) return false;
        const int z = (int)(L / nwg); int w = (int)(L - (long)z * nwg);
        { const int q = nwg / 8, r = nwg % 8, xcd = w % 8, off = w / 8; w = (xcd < r ? xcd * (q + 1) : r * (q + 1) + (xcd - r) * q) + off; }
        const int nig = 8 * nN, gid = w / nig, fm = gid * 8, gsz = (nM - fm) < 8 ? (nM - fm) : 8;
        u.pm = fm + ((w % nig) % gsz); u.pn = (w % nig) / gsz; u.z = z; u.seg = seg;
        const int k0 = (int)((k0pack >> (8 * seg)) & 255u) * BK;
        u.nt = (int)((ntpack >> (8 * seg)) & 255u);
        u.A = A + (size_t)z * a_z + (size_t)u.pm * a_tile + (size_t)k0 * 2;
        u.B = B + (size_t)z * b_z + (size_t)u.pn * b_tile + (size_t)k0 * 2;
        return true;
    }
};
__device__ __forceinline__ Sched make_sched(const void* A, int lda, const void* B, int ldb, int nM, int nN, int K) {
    Sched s; s.A = (const char*)A; s.B = (const char*)B; s.nM = nM; s.nN = nN; s.nZ = 1; s.nseg = 1; s.G = gridDim.x; s.c = blockIdx.x;
    s.a_tile = (size_t)BM * lda * 2; s.b_tile = (size_t)BM * ldb * 2; s.a_z = 0; s.b_z = 0;
    s.k0pack = 0u; s.ntpack = (unsigned)(K / BK); return s;
}

template <class Epi>
__device__ __forceinline__ void gemm_phase(LAS unsigned char* lds, const int lda, const int ldb, const Sched& S, const Epi& E) {
    const int tid = opaque_tid(), wid = __builtin_amdgcn_readfirstlane(tid >> 6), lane = tid & 63, wr = wid >> 2, wc = wid & 3, fr = lane & 15, fq = lane >> 4;
    unsigned voffA[2], voffB[2];
#pragma unroll
    for (int i = 0; i < 2; ++i) { int R, C; stage_rc(tid * 16 + i * 8192, R, C); const int Rb = (R & ~31) + perm32(R & 31);
        voffA[i] = (unsigned)(R * lda + C) * 2u; voffB[i] = (unsigned)(Rb * ldb + C) * 2u; }
    const size_t kstep = (size_t)(BK * 2);
    const size_t hstepA = (size_t)HALF * lda * 2, hstepB = (size_t)HALF * ldb * 2;
    const unsigned ldsw = (unsigned)wid * 1024u;
    const int aoff = lds_byte(wr * 64 + fr, fq * 8), boff = lds_byte(wc * 32 + fr, fq * 8);
#define PG8_SA(b, h) (((b) * 2 + (h)) * HTB)
#define PG8_SB(b, h) ((4 + (b) * 2 + (h)) * HTB)
#define PG8_STAGE(bufoff, gbase, voff) do { _Pragma("unroll") for (int _i = 0; _i < 2; ++_i) \
        __builtin_amdgcn_global_load_lds((const unsigned*)((const char*)(gbase) + (voff)[_i]), (LAS unsigned*)(lds + (bufoff) + ldsw + _i * 8192), 16, 0, 0); } while (0)
#define PG8_LDA(dst, b, h) do { _Pragma("unroll") for (int m = 0; m < 4; ++m) _Pragma("unroll") for (int k = 0; k < 2; ++k) dst[m][k] = *(const LAS bf16x8*)(lds + PG8_SA(b, h) + aoff + m * 2048 + k * 1024); } while (0)
#define PG8_LDB(dst, b, h) do { _Pragma("unroll") for (int n = 0; n < 2; ++n) _Pragma("unroll") for (int k = 0; k < 2; ++k) dst[n][k] = *(const LAS bf16x8*)(lds + PG8_SB(b, h) + boff + n * 2048 + k * 1024); } while (0)
#define PG8_MMA(ai, bj, At, Bt) do { __builtin_amdgcn_s_setprio(1); _Pragma("unroll") for (int m = 0; m < 4; ++m) _Pragma("unroll") for (int n = 0; n < 2; ++n) _Pragma("unroll") for (int k = 0; k < 2; ++k) \
        acc[ai][bj][m][n] = __builtin_amdgcn_mfma_f32_16x16x32_bf16(Bt[n][k], At[m][k], acc[ai][bj][m][n], 0, 0, 0); __builtin_amdgcn_s_setprio(0); } while (0)
#define PG8_WAIT_V(n) asm volatile("s_waitcnt vmcnt(" #n ")" ::: "memory")
#define PG8_WAIT_L(n) asm volatile("s_waitcnt lgkmcnt(" #n ")" ::: "memory")
#define PG8_BAR __builtin_amdgcn_s_barrier()
#define PG8_SCHED __builtin_amdgcn_sched_barrier(0)
    GUnit cur, nxt; int ui = 0;
    if (!S.next(0, cur)) return;
    f32x4 acc[2][2][4][2];
#pragma unroll
    for (int a = 0; a < 2; ++a)
#pragma unroll
        for (int b = 0; b < 2; ++b)
#pragma unroll
            for (int m = 0; m < 4; ++m)
#pragma unroll
                for (int n = 0; n < 2; ++n) acc[a][b][m][n] = (f32x4){0.f, 0.f, 0.f, 0.f};
    bf16x8 At[4][2], B0[2][2], B1[2][2];
    const char* cA = cur.A; const char* cB = cur.B;
    PG8_STAGE(PG8_SB(0, 0), cB, voffB); PG8_STAGE(PG8_SB(0, 1), cB + hstepB, voffB); PG8_STAGE(PG8_SA(0, 0), cA, voffA); PG8_STAGE(PG8_SA(0, 1), cA + hstepA, voffA);
    if (wr == 1) PG8_BAR;
    PG8_WAIT_V(2); PG8_BAR;
    PG8_STAGE(PG8_SB(1, 0), cB + kstep, voffB); PG8_STAGE(PG8_SA(1, 0), cA + kstep, voffA); PG8_STAGE(PG8_SB(1, 1), cB + hstepB + kstep, voffB);
    PG8_WAIT_V(6); PG8_BAR;
    for (;;) {
        const bool has_next = S.next(ui + 1, nxt);
        const char* nA = has_next ? nxt.A : cA; const char* nB = has_next ? nxt.B : cB;
        const int nt = cur.nt;
        for (int t = 0; t < nt; t += 2) {
            const bool last = (t == nt - 2);
            const char* a1 = cA + (size_t)(t + 1) * kstep;
            const char* a2 = last ? nA : cA + (size_t)(t + 2) * kstep; const char* b2 = last ? nB : cB + (size_t)(t + 2) * kstep;
            const char* a3 = a2 + kstep; const char* b3 = b2 + kstep;
            PG8_LDB(B0, 0, 0); PG8_LDB(B1, 0, 1); PG8_SCHED; PG8_LDA(At, 0, 0); PG8_STAGE(PG8_SA(1, 1), a1 + hstepA, voffA);
            PG8_WAIT_V(8); PG8_WAIT_L(0); PG8_BAR; PG8_MMA(0, 0, At, B0); PG8_MMA(0, 1, At, B1); PG8_BAR; PG8_SCHED;
            PG8_LDA(At, 0, 1); PG8_STAGE(PG8_SB(0, 0), b2, voffB); PG8_STAGE(PG8_SB(0, 1), b2 + hstepB, voffB); PG8_STAGE(PG8_SA(0, 0), a2, voffA);
            PG8_WAIT_V(8); PG8_WAIT_L(0); PG8_BAR; PG8_MMA(1, 0, At, B0); PG8_MMA(1, 1, At, B1); PG8_BAR; PG8_SCHED;
            PG8_LDB(B0, 1, 0); PG8_LDB(B1, 1, 1); PG8_SCHED; PG8_LDA(At, 1, 0); PG8_STAGE(PG8_SA(0, 1), a2 + hstepA, voffA);
            PG8_WAIT_V(8); PG8_WAIT_L(0); PG8_BAR; PG8_MMA(0, 0, At, B0); PG8_MMA(0, 1, At, B1); PG8_BAR; PG8_SCHED;
            PG8_LDA(At, 1, 1); PG8_STAGE(PG8_SB(1, 0), b3, voffB); PG8_STAGE(PG8_SB(1, 1), b3 + hstepB, voffB); PG8_STAGE(PG8_SA(1, 0), a3, voffA);
            PG8_WAIT_V(8); PG8_WAIT_L(0); PG8_BAR; PG8_MMA(1, 0, At, B0); PG8_MMA(1, 1, At, B1); PG8_BAR; PG8_SCHED;
        }
        if (wr == 0) PG8_BAR;
        const bool zero = E(acc, cur, wr, wc, fr, fq);
        if (!has_next) break;
        if (zero) {
#pragma unroll
        for (int a = 0; a < 2; ++a)
#pragma unroll
            for (int b = 0; b < 2; ++b)
#pragma unroll
                for (int m = 0; m < 4; ++m)
#pragma unroll
                    for (int n = 0; n < 2; ++n) acc[a][b][m][n] = (f32x4){0.f, 0.f, 0.f, 0.f};
        }
        cur = nxt; cA = nA; cB = nB; ++ui;
        if (wr == 1) PG8_BAR;
    }
    PG8_WAIT_V(0);
    PG8_BAR;
#undef PG8_SA
#undef PG8_SB
#undef PG8_STAGE
#undef PG8_LDA
#undef PG8_LDB
#undef PG8_MMA
#undef PG8_WAIT_V
#undef PG8_WAIT_L
#undef PG8_BAR
#undef PG8_SCHED
}

#define EPI_LOOP_AM _Pragma("unroll") for (int ai = 0; ai < 2; ++ai) _Pragma("unroll") for (int m = 0; m < 4; ++m)
typedef f32x4 acc_t[2][2][4][2];

struct EpiFfnUp {
    bf16_t* H;
    __device__ __forceinline__ bool operator()(acc_t& acc, const GUnit& u, int wr, int wc, int fr, int fq) const {
        const int row0 = u.pm * 256 + wr * 64 + fr, col0 = u.pn * 128 + wc * 32 + fq * 8;
        EPI_LOOP_AM {
            bf16_t* dst = H + (size_t)(row0 + ai * 128 + m * 16) * DFF + col0;
            float h[8];
#pragma unroll
            for (int n = 0; n < 2; ++n)
#pragma unroll
                for (int j = 0; j < 4; ++j) { const float g = acc[ai][0][m][n][j], up = acc[ai][1][m][n][j]; h[n * 4 + j] = g * fast_sigmoid(g) * up; }
            u32x4 w; w.x = pk2(h[0], h[1]); w.y = pk2(h[2], h[3]); w.z = pk2(h[4], h[5]); w.w = pk2(h[6], h[7]);
            *(u32x4*)dst = w;
        }
        return true;
    }
};
struct EpiResid {
    const float* R; float* V; float s;
    __device__ __forceinline__ bool operator()(acc_t& acc, const GUnit& u, int wr, int wc, int fr, int fq) const {
        const int row0 = u.pm * 256 + wr * 64 + fr, col0 = u.pn * 256 + wc * 32 + fq * 8;
        EPI_LOOP_AM {
#pragma unroll
            for (int bj = 0; bj < 2; ++bj) {
                const size_t off = (size_t)(row0 + ai * 128 + m * 16) * DM + col0 + bj * 128;
#pragma unroll
                for (int n = 0; n < 2; ++n) { const f32x4 r = *(const f32x4*)(R + off + 4 * n); *(f32x4*)(V + off + 4 * n) = r * ALPHA + acc[ai][bj][m][n] * s; }
            }
        }
        return true;
    }
};
struct EpiWin {
    bf16_t* PROJ; bf16_t* UX;
    __device__ __forceinline__ bool operator()(acc_t& acc, const GUnit& u, int wr, int wc, int fr, int fq) const {
        const int row0 = u.pm * 256 + wr * 64 + fr, col0 = u.pn * 256 + wc * 32 + fq * 8, pn = u.pn;
        EPI_LOOP_AM {
            const int row = row0 + ai * 128 + m * 16;
#pragma unroll
            for (int bj = 0; bj < 2; ++bj) {
                const int col = col0 + bj * 128;
                f32x4 v0 = acc[ai][bj][m][0], v1 = acc[ai][bj][m][1];
                if (pn >= 7) {
#pragma unroll
                    for (int j = 0; j < 4; ++j) { v0[j] = fast_sigmoid(v0[j]); v1[j] = fast_sigmoid(v1[j]); }
                } else if (pn == 4 || pn == 5) { v0 = v0 * 0.125f; v1 = v1 * 0.125f; }
                u32x4 w; w.x = pk2(v0[0], v0[1]); w.y = pk2(v0[2], v0[3]); w.z = pk2(v1[0], v1[1]); w.w = pk2(v1[2], v1[3]);
                bf16_t* dst;
                if (pn == 3) { const int cu = col - 768, g = cu >> 4, ch = cu & 15; dst = UX + ((size_t)g * 512 + (row >> 5)) * 640 + (row & 31) * 16 + ch; }
                else dst = PROJ + (size_t)row * DIN + col;
                *(u32x4*)dst = w;
            }
        }
        return true;
    }
};
struct EpiSsm1 {
    float* XLOC;
    __device__ __forceinline__ bool operator()(acc_t& acc, const GUnit& u, int wr, int wc, int fr, int fq) const {
        const int row0 = u.pm * 256 + wr * 64 + fr, col0 = wc * 32 + fq * 8;
        EPI_LOOP_AM {
            float* dst = XLOC + ((size_t)u.z * 512 + row0 + ai * 128 + m * 16) * 128 + col0;
            *(f32x4*)dst = acc[ai][0][m][0]; *(f32x4*)(dst + 4) = acc[ai][0][m][1];
        }
        return true;
    }
};
struct EpiSsm2 {
    const bf16_t* UX; const float* Dsk; bf16_t* YPRE;
    __device__ __forceinline__ bool operator()(acc_t& acc, const GUnit& u, int wr, int wc, int fr, int fq) const {
        const int row0 = u.pm * 256 + wr * 64 + fr, g = u.z;
#pragma unroll
        for (int bj = 0; bj < 2; ++bj) {
            const int colidx = u.pn * 256 + bj * 128 + wc * 32 + fq * 8, t = colidx >> 4, c0 = colidx & 15;
            const f32x4 d0 = *(const f32x4*)(Dsk + g * 16 + c0), d1 = *(const f32x4*)(Dsk + g * 16 + c0 + 4);
            EPI_LOOP_AM {
                const int rowg = row0 + ai * 128 + m * 16;
                const u32x4 uw = *(const u32x4*)(UX + ((size_t)g * 512 + rowg) * 640 + colidx);
                float uf[8]; unpack8(uw, uf);
                float y[8];
#pragma unroll
                for (int j = 0; j < 4; ++j) { y[j] = acc[ai][bj][m][0][j] + d0[j] * uf[j]; y[4 + j] = acc[ai][bj][m][1][j] + d1[j] * uf[4 + j]; }
#pragma unroll
                for (int j = 0; j < 8; ++j) { const float v = y[j]; y[j] = v * fast_sigmoid(1.5957691216057308f * (v + 0.044715f * v * v * v)); }
                u32x4 w; w.x = pk2(y[0], y[1]); w.y = pk2(y[2], y[3]); w.z = pk2(y[4], y[5]); w.w = pk2(y[6], y[7]);
                *(u32x4*)(YPRE + ((size_t)rowg * 32 + t) * 256 + g * 16 + c0) = w;
            }
        }
        return true;
    }
};
struct EpiGlu {
    const bf16_t* YPRE; bf16_t* YCAT;
    __device__ __forceinline__ bool operator()(acc_t& acc, const GUnit& u, int wr, int wc, int fr, int fq) const {
        const int row0 = u.pm * 256 + wr * 64 + fr, col0 = wc * 32 + fq * 8;
        EPI_LOOP_AM {
            const int row = row0 + ai * 128 + m * 16;
#pragma unroll
            for (int bj = 0; bj < 2; ++bj) {
                const int col = col0 + bj * 128;
                const u32x4 yw = *(const u32x4*)(YPRE + (size_t)row * 256 + col);
                float y[8]; unpack8(yw, y);
#pragma unroll
                for (int j = 0; j < 4; ++j) { y[j] *= fast_sigmoid(acc[ai][bj][m][0][j]); y[4 + j] *= fast_sigmoid(acc[ai][bj][m][1][j]); }
                u32x4 w; w.x = pk2(y[0], y[1]); w.y = pk2(y[2], y[3]); w.z = pk2(y[4], y[5]); w.w = pk2(y[6], y[7]);
                *(u32x4*)(YCAT + (size_t)row * DM + 256 + col) = w;
            }
        }
        return true;
    }
};
struct EpiBranch {
    const bf16_t* PROJ; bf16_t* MERGED;
    __device__ __forceinline__ bool operator()(acc_t& acc, const GUnit& u, int wr, int wc, int fr, int fq) const {
        const int row0 = u.pm * 256 + wr * 64 + fr, col0 = u.pn * 256 + wc * 32 + fq * 8, seg = u.seg;
        const int oa = (seg == 2) ? 2048 : seg * 1024, ob = (seg == 2) ? 2048 : seg * 1024 + 1024;
        EPI_LOOP_AM {
            const int row = row0 + ai * 128 + m * 16;
#pragma unroll
            for (int bj = 0; bj < 2; ++bj) {
                const int col = col0 + bj * 128;
                const bf16_t* gp = PROJ + (size_t)row * DIN + 1792 + col;
                const u32x4 a = *(const u32x4*)(gp + oa), b = *(const u32x4*)(gp + ob);
                f32x4 f0, f1;
                f0[0] = bf_lo(a.x); f0[1] = bf_hi(a.x); f0[2] = bf_lo(a.y); f0[3] = bf_hi(a.y); f1[0] = bf_lo(a.z); f1[1] = bf_hi(a.z); f1[2] = bf_lo(a.w); f1[3] = bf_hi(a.w);
                if (seg != 2) {
                    f0[0] *= __builtin_amdgcn_rcpf(bf_lo(b.x)); f0[1] *= __builtin_amdgcn_rcpf(bf_hi(b.x)); f0[2] *= __builtin_amdgcn_rcpf(bf_lo(b.y)); f0[3] *= __builtin_amdgcn_rcpf(bf_hi(b.y));
                    f1[0] *= __builtin_amdgcn_rcpf(bf_lo(b.z)); f1[1] *= __builtin_amdgcn_rcpf(bf_hi(b.z)); f1[2] *= __builtin_amdgcn_rcpf(bf_lo(b.w)); f1[3] *= __builtin_amdgcn_rcpf(bf_hi(b.w));
                }
                const f32x4 v0 = acc[ai][bj][m][0] * f0, v1 = acc[ai][bj][m][1] * f1;
                acc[ai][bj][m][0] = v0; acc[ai][bj][m][1] = v1;
                if (seg == 2) {
                    u32x4 w; w.x = pk2(v0[0], v0[1]); w.y = pk2(v0[2], v0[3]); w.z = pk2(v1[0], v1[1]); w.w = pk2(v1[2], v1[3]);
                    *(u32x4*)(MERGED + (size_t)row * DM + col) = w;
                }
            }
        }
        return seg == 2;
    }
};
}

struct Params { const float* in[30]; float* out; unsigned char* ws; };

struct Ctx { int tid, lane, wave, gw, NGW, gtid, NT; LAS unsigned char* lds; };
__device__ __forceinline__ Ctx make_ctx(LAS unsigned char* lds) { Ctx C; C.lds = lds; C.tid = opaque_tid(); C.lane = C.tid & 63; C.wave = __builtin_amdgcn_readfirstlane(C.tid >> 6);
    C.gw = blockIdx.x * 8 + C.wave; C.NGW = gridDim.x * 8; C.gtid = blockIdx.x * 512 + C.tid; C.NT = gridDim.x * 512; return C; }

__device__ __forceinline__ void transpose_item(const float* W, int N, int k0, int n0, bf16_t* WT, int ldt, int drow0, int dk0, LAS float* scr, int lane) {
#pragma unroll 8
    for (int i = 0; i < 32; ++i) { const int kk = 2 * i + (lane >> 5); scr[kk * 33 + (lane & 31)] = W[(size_t)(k0 + kk) * N + n0 + (lane & 31)]; }
    asm volatile("s_waitcnt lgkmcnt(0)" ::: "memory");
    const int c = lane & 7;
#pragma unroll
    for (int j = 0; j < 4; ++j) { const int n = (lane >> 3) + 8 * j; const LAS float* s = scr + (8 * c) * 33 + n;
        u32x4 o; o.x = pk2(s[0 * 33], s[1 * 33]); o.y = pk2(s[2 * 33], s[3 * 33]); o.z = pk2(s[4 * 33], s[5 * 33]); o.w = pk2(s[6 * 33], s[7 * 33]);
        *(u32x4*)(WT + (size_t)(drow0 + n) * ldt + dk0 + k0 + 8 * c) = o; }
    asm volatile("s_waitcnt lgkmcnt(0)" ::: "memory");
}
__device__ __forceinline__ bool transpose_job(int& r, const float* W, int K, int N, bf16_t* WT, int ldt, int dk0, int mode, LAS float* scr, int lane) {
    const int nblk = N / 32, items = (K / 64) * nblk;
    if (r >= items) { r -= items; return false; }
    const int kb = r / nblk, nb = r % nblk, n0 = nb * 32;
    int drow0 = n0;
    if (mode) drow0 = 256 * (n0 >> 7) + (n0 & 127) + (mode == 2 ? 128 : 0);
    transpose_item(W, N, kb * 64, n0, WT, ldt, drow0, dk0, scr, lane);
    return true;
}
__device__ __forceinline__ void apow(float lr, float li, float dt, float k, float& re, float& im) {
    const float mag = __expf(k * lr * dt);
    float turns = k * (li * dt) * 0.15915494309189535f;
    turns = turns - floorf(turns);
    re = mag * __builtin_amdgcn_cosf(turns); im = mag * __builtin_amdgcn_sinf(turns);
}
__device__ __forceinline__ void ssm_coef(float lr, float li, float dt, float& cr, float& ci) {
    float ar, ai; apow(lr, li, dt, 1.0f, ar, ai);
    const float nr = ar - 1.0f, ni = ai, den = lr * lr + li * li;
    cr = (nr * lr + ni * li) / den; ci = (ni * lr - nr * li) / den;
}

__device__ __forceinline__ void prep_layer(const Params& P, int l, const Ctx& C) {
    unsigned char* ws = P.ws;
    LAS float* scr = (LAS float*)(C.lds + C.wave * 16384);
    const size_t oGU = (size_t)l * DM * DFF, oIN = (size_t)l * DM * DIN;
    constexpr int I_GU = (DM / 64) * (DFF / 32), I_D = (DFF / 64) * (DM / 32), I_IN = (DM / 64) * (DIN / 32), I_BC = 4 * 32, I_BA = 8 * 32, I_O = 16 * 32, I_G = 4 * 8;
    constexpr int NITEMS = 4 * I_GU + 2 * I_D + I_IN + 2 * I_BC + I_BA + I_O + I_G;
    for (int it = C.gw; it < NITEMS; it += C.NGW) {
        int r = it;
        if (transpose_job(r, P.in[1] + oGU, DM, DFF, (bf16_t*)(ws + WS_WGU1), DM, 0, 1, scr, C.lane)) continue;
        if (transpose_job(r, P.in[2] + oGU, DM, DFF, (bf16_t*)(ws + WS_WGU1), DM, 0, 2, scr, C.lane)) continue;
        if (transpose_job(r, P.in[3] + oGU, DFF, DM, (bf16_t*)(ws + WS_WD1), DFF, 0, 0, scr, C.lane)) continue;
        if (transpose_job(r, P.in[25] + oGU, DM, DFF, (bf16_t*)(ws + WS_WGU2), DM, 0, 1, scr, C.lane)) continue;
        if (transpose_job(r, P.in[26] + oGU, DM, DFF, (bf16_t*)(ws + WS_WGU2), DM, 0, 2, scr, C.lane)) continue;
        if (transpose_job(r, P.in[27] + oGU, DFF, DM, (bf16_t*)(ws + WS_WD2), DFF, 0, 0, scr, C.lane)) continue;
        if (transpose_job(r, P.in[6] + oIN, DM, DIN, (bf16_t*)(ws + WS_WIN), DM, 0, 0, scr, C.lane)) continue;
        if (transpose_job(r, P.in[19] + (size_t)l * 256 * DM, 256, DM, (bf16_t*)(ws + WS_WBR), DM, 0, 0, scr, C.lane)) continue;
        if (transpose_job(r, P.in[20] + (size_t)l * 256 * DM, 256, DM, (bf16_t*)(ws + WS_WBR), DM, 256, 0, scr, C.lane)) continue;
        if (transpose_job(r, P.in[21] + (size_t)l * 512 * DM, 512, DM, (bf16_t*)(ws + WS_WBR), DM, 512, 0, scr, C.lane)) continue;
        if (transpose_job(r, P.in[22] + (size_t)l * DM * DM, DM, DM, (bf16_t*)(ws + WS_WOUT), DM, 0, 0, scr, C.lane)) continue;
        transpose_job(r, P.in[17] + (size_t)l * 256 * 256, 256, 256, (bf16_t*)(ws + WS_WGLU), 256, 0, 0, scr, C.lane);
    }
    const float* a_re = P.in[9] + l * 1024; const float* a_im = P.in[10] + l * 1024; const float* log_dt = P.in[11] + l * 16;
    const float* b_re = P.in[12] + (size_t)l * 16384; const float* b_im = P.in[13] + (size_t)l * 16384;
    const float* c_re = P.in[14] + (size_t)l * 16384; const float* c_im = P.in[15] + (size_t)l * 16384;
    bf16_t* TF = (bf16_t*)(ws + WS_TF); bf16_t* EM = (bf16_t*)(ws + WS_E);
    const int lane = C.lane;
    for (int it = C.gw; it < 2048 + 512 + 1024; it += C.NGW) {
        if (it < 2048) {
            const int g = it >> 7, k = (it >> 2) & 31, cq = it & 3, c = 4 * cq + (lane >> 4), cp = lane & 15;
            const float dt = __expf(log_dt[g]), lr = a_re[g * 64 + lane], li = a_im[g * 64 + lane];
            float cr, ci, pr, pi; ssm_coef(lr, li, dt, cr, ci); apow(lr, li, dt, (float)k, pr, pi);
            const float akr = pr * cr - pi * ci, aki = pr * ci + pi * cr;
            float sum = 0.f;
            for (int p = 0; p < 64; ++p) {
                const float wr_ = __shfl(akr, p), wi_ = __shfl(aki, p);
                const float Cr = c_re[(g * 16 + c) * 64 + p], Ci = c_im[(g * 16 + c) * 64 + p];
                const float Br = b_re[(g * 64 + p) * 16 + cp], Bi = b_im[(g * 64 + p) * 16 + cp];
                sum += Cr * (wr_ * Br - wi_ * Bi) - Ci * (wr_ * Bi + wi_ * Br);
            }
            const bf16_t v = (bf16_t)(pk2(sum, 0.f) & 0xffffu);
            bf16_t* Tg = TF + (size_t)g * 512 * 640;
            for (int t = k; t < 32; ++t) Tg[(size_t)(t * 16 + c) * 640 + (t - k) * 16 + cp] = v;
            if (k >= 1) for (int t = 0; t < 32 - k; ++t) Tg[(size_t)(t * 16 + c) * 640 + (t + k) * 16 + cp] = 0;
        } else if (it < 2048 + 512) {
            const int j = it - 2048, g = j >> 5, t = j & 31;
            const float dt = __expf(log_dt[g]), lr = a_re[g * 64 + lane], li = a_im[g * 64 + lane];
            float pr, pi; apow(lr, li, dt, (float)(t + 1), pr, pi);
            bf16_t* Tg = TF + (size_t)g * 512 * 640;
            for (int c = 0; c < 16; ++c) {
                const float Cr = c_re[(g * 16 + c) * 64 + lane], Ci = c_im[(g * 16 + c) * 64 + lane];
                const float Wr = Cr * pr - Ci * pi, Wi = Cr * pi + Ci * pr;
                const unsigned w = pk2(Wr, -Wi);
                Tg[(size_t)(t * 16 + c) * 640 + 512 + lane] = (bf16_t)(w & 0xffffu);
                Tg[(size_t)(t * 16 + c) * 640 + 576 + lane] = (bf16_t)(w >> 16);
            }
        } else {
            const int j = it - 2560, g = j >> 6, p = j & 63, s = lane >> 1, c0 = (lane & 1) * 8;
            const float dt = __expf(log_dt[g]), lr = a_re[g * 64 + p], li = a_im[g * 64 + p];
            float cr, ci, pr, pi; ssm_coef(lr, li, dt, cr, ci); apow(lr, li, dt, (float)(31 - s), pr, pi);
            const float wr_ = pr * cr - pi * ci, wi_ = pr * ci + pi * cr;
            float re[8], im[8];
#pragma unroll
            for (int e = 0; e < 8; ++e) { const float Br = b_re[(g * 64 + p) * 16 + c0 + e], Bi = b_im[(g * 64 + p) * 16 + c0 + e]; re[e] = wr_ * Br - wi_ * Bi; im[e] = wr_ * Bi + wi_ * Br; }
            u32x4 w0, w1; w0.x = pk2(re[0], re[1]); w0.y = pk2(re[2], re[3]); w0.z = pk2(re[4], re[5]); w0.w = pk2(re[6], re[7]);
            w1.x = pk2(im[0], im[1]); w1.y = pk2(im[2], im[3]); w1.z = pk2(im[4], im[5]); w1.w = pk2(im[6], im[7]);
            *(u32x4*)(EM + (size_t)(g * 128 + p) * 512 + s * 16 + c0) = w0;
            *(u32x4*)(EM + (size_t)(g * 128 + 64 + p) * 512 + s * 16 + c0) = w1;
        }
    }
    for (int i = C.gtid; i < 8192; i += C.NT) ((u32x4*)(EM + (size_t)2048 * 512))[i] = (u32x4){0u, 0u, 0u, 0u};
}

__device__ __forceinline__ void ln_pass(const float* V, const float* gam, const float* bet, float* X, bf16_t* XB, const Ctx& C) {
    for (int m = C.gw; m < MTOK; m += C.NGW) {
        const f32x4* vr = (const f32x4*)(V + (size_t)m * DM) + C.lane;
        f32x4 v[4]; float s = 0.f;
#pragma unroll
        for (int j = 0; j < 4; ++j) { v[j] = vr[64 * j]; s += (v[j].x + v[j].y) + (v[j].z + v[j].w); }
        const float mean = wave_sum(s) * (1.f / DM); float s2 = 0.f;
#pragma unroll
        for (int j = 0; j < 4; ++j) { v[j] = v[j] - mean; s2 += (v[j].x * v[j].x + v[j].y * v[j].y) + (v[j].z * v[j].z + v[j].w * v[j].w); }
        const float rstd = 1.f / sqrtf(wave_sum(s2) * (1.f / DM) + LN_EPS);
        f32x4* xo = (f32x4*)(X + (size_t)m * DM) + C.lane; u32x2* bo = (u32x2*)(XB + (size_t)m * DM) + C.lane;
#pragma unroll
        for (int j = 0; j < 4; ++j) {
            const f32x4 g = ((const f32x4*)gam)[C.lane + 64 * j], b = ((const f32x4*)bet)[C.lane + 64 * j];
            const f32x4 o = v[j] * rstd * g + b;
            xo[64 * j] = o; u32x2 w; w.x = pk2(o.x, o.y); w.y = pk2(o.z, o.w); bo[64 * j] = w;
        }
    }
}

__device__ __forceinline__ void conv_pass(const bf16_t* PROJ, const float* cw, const float* cb, bf16_t* YCAT, const Ctx& C) {
    for (int idx = C.gtid; idx < MTOK * 32; idx += C.NT) {
        const int tok = idx >> 5, c8 = (idx & 31) * 8, s = tok & (SEQ - 1);
        const bf16_t* base = PROJ + (size_t)tok * DIN + c8;
        float B[8], z0[8], z1[8], z2[8], t0[8], t1[8];
        unpack8(*(const u32x4*)base, B);
        unpack8(*(const u32x4*)(base + 256), t0); unpack8(*(const u32x4*)(base + 512), t1);
#pragma unroll
        for (int e = 0; e < 8; ++e) z0[e] = t0[e] * t1[e];
        if (s >= 1) { unpack8(*(const u32x4*)(base - DIN + 256), t0); unpack8(*(const u32x4*)(base - DIN + 512), t1);
#pragma unroll
            for (int e = 0; e < 8; ++e) z1[e] = t0[e] * t1[e]; }
        else {
#pragma unroll
            for (int e = 0; e < 8; ++e) z1[e] = 0.f; }
        if (s >= 2) { unpack8(*(const u32x4*)(base - 2 * DIN + 256), t0); unpack8(*(const u32x4*)(base - 2 * DIN + 512), t1);
#pragma unroll
            for (int e = 0; e < 8; ++e) z2[e] = t0[e] * t1[e]; }
        else {
#pragma unroll
            for (int e = 0; e < 8; ++e) z2[e] = 0.f; }
        float y[8];
#pragma unroll
        for (int e = 0; e < 8; ++e) y[e] = B[e] * (cw[c8 + e] * z2[e] + cw[256 + c8 + e] * z1[e] + cw[512 + c8 + e] * z0[e] + cb[c8 + e]);
        u32x4 w; w.x = pk2(y[0], y[1]); w.y = pk2(y[2], y[3]); w.z = pk2(y[4], y[5]); w.w = pk2(y[6], y[7]);
        *(u32x4*)(YCAT + (size_t)tok * DM + c8) = w;
    }
}

constexpr int ATT_KROW = 144, ATT_VROW = 528, ATT_VOFF = 256 * ATT_KROW;
__device__ __forceinline__ void attn_unit(LAS unsigned char* lds, const bf16_t* PROJ, bf16_t* YCAT, const float* sinks, int unit, int tid) {
    const int b = unit >> 7, kvh = (unit >> 6) & 1, nb = unit & 63;
    const int wid = tid >> 6, lane = tid & 63, r = lane & 31, h = lane >> 5;
    const long tok0 = (long)b * SEQ + nb * 128;
#pragma unroll
    for (int r4 = 0; r4 < 4; ++r4) {
        const int idx = tid + 512 * r4, key = idx >> 3, c = idx & 7;
        u32x4 v = (u32x4){0u, 0u, 0u, 0u};
        if (nb > 0 || key >= 128) v = *(const u32x4*)(PROJ + (size_t)(tok0 - 128 + key) * DIN + 1536 + kvh * 64 + c * 8);
        *(LAS u32x4*)(lds + key * ATT_KROW + c * 16) = v;
    }
#pragma unroll
    for (int r2 = 0; r2 < 2; ++r2) {
        const int item = tid + 512 * r2, pair = item & 127, c = item >> 7, key0 = 2 * pair;
        u32x4 v0 = (u32x4){0u, 0u, 0u, 0u}, v1 = v0;
        if (nb > 0 || key0 >= 128) { const bf16_t* src = PROJ + (size_t)(tok0 - 128 + key0) * DIN + 1664 + kvh * 64 + c * 8; v0 = *(const u32x4*)src; v1 = *(const u32x4*)(src + DIN); }
        const unsigned a0[4] = {v0.x, v0.y, v0.z, v0.w}, a1[4] = {v1.x, v1.y, v1.z, v1.w};
#pragma unroll
        for (int e = 0; e < 8; ++e) {
            const unsigned lo = (e & 1) ? (a0[e >> 1] >> 16) : (a0[e >> 1] & 0xffffu), hi = (e & 1) ? (a1[e >> 1] >> 16) : (a1[e >> 1] & 0xffffu);
            *(LAS unsigned*)(lds + ATT_VOFF + (8 * c + e) * ATT_VROW + key0 * 2) = lo | (hi << 16);
        }
    }
    __syncthreads();
    const int hq = kvh * 4 + (wid >> 1), qh = wid & 1;
    const float sink = sinks[hq];
    const float L2E = 1.4426950408889634f;
#pragma unroll 1
    for (int sub = 0; sub < 2; ++sub) {
        const int tql = qh * 64 + sub * 32;
        const bf16_t* qp = PROJ + (size_t)(tok0 + tql + r) * DIN + 1024 + hq * 64 + 8 * h;
        bf16x8 qf[4];
#pragma unroll
        for (int ks = 0; ks < 4; ++ks) qf[ks] = *(const bf16x8*)(qp + 16 * ks);
        f32x16 st[5];
#pragma unroll
        for (int kt = 0; kt < 5; ++kt) {
            f32x16 a;
#pragma unroll
            for (int i = 0; i < 16; ++i) a[i] = 0.f;
#pragma unroll
            for (int ks = 0; ks < 4; ++ks) {
                const bf16x8 kf = *(const LAS bf16x8*)(lds + (tql + 32 * kt + r) * ATT_KROW + (16 * ks + 8 * h) * 2);
                a = __builtin_amdgcn_mfma_f32_32x32x16_bf16(kf, qf[ks], a, 0, 0, 0);
            }
            st[kt] = a;
        }
        float mx = sink;
#pragma unroll
        for (int kt = 0; kt < 5; ++kt) {
            const bool tile_ok = (nb > 0) || (tql + 32 * kt >= 128);
#pragma unroll
            for (int i = 0; i < 16; ++i) {
                const int ki = (i & 3) + 8 * (i >> 2) + 4 * h;
                bool ok = tile_ok;
                if (kt == 0) ok = ok && (ki > r);
                if (kt == 4) ok = ok && (ki <= r);
                const float s = ok ? st[kt][i] : -INFINITY;
                st[kt][i] = s; mx = fmaxf(mx, s);
            }
        }
        mx = fmaxf(mx, __shfl_xor(mx, 32));
        float sum = 0.f;
#pragma unroll
        for (int kt = 0; kt < 5; ++kt)
#pragma unroll
            for (int i = 0; i < 16; ++i) { const float p = __builtin_amdgcn_exp2f((st[kt][i] - mx) * L2E); st[kt][i] = p; sum += p; }
        sum += __shfl_xor(sum, 32);
        const float inv = 1.0f / (sum + __builtin_amdgcn_exp2f((sink - mx) * L2E));
        f32x16 o[2];
#pragma unroll
        for (int i = 0; i < 16; ++i) { o[0][i] = 0.f; o[1][i] = 0.f; }
#pragma unroll
        for (int kt = 0; kt < 5; ++kt)
#pragma unroll
            for (int s2 = 0; s2 < 2; ++s2) {
                u32x4 pw; pw.x = pk2(st[kt][8 * s2 + 0], st[kt][8 * s2 + 1]); pw.y = pk2(st[kt][8 * s2 + 2], st[kt][8 * s2 + 3]);
                pw.z = pk2(st[kt][8 * s2 + 4], st[kt][8 * s2 + 5]); pw.w = pk2(st[kt][8 * s2 + 6], st[kt][8 * s2 + 7]);
                const bf16x8 pb = __builtin_bit_cast(bf16x8, pw);
#pragma unroll
                for (int dt = 0; dt < 2; ++dt) {
                    const LAS unsigned char* vp = lds + ATT_VOFF + (32 * dt + r) * ATT_VROW + (tql + 32 * kt + 16 * s2 + 4 * h) * 2;
                    const u32x2 lo = *(const LAS u32x2*)vp, hi = *(const LAS u32x2*)(vp + 16);
                    u32x4 vw; vw.x = lo.x; vw.y = lo.y; vw.z = hi.x; vw.w = hi.y;
                    o[dt] = __builtin_amdgcn_mfma_f32_32x32x16_bf16(__builtin_bit_cast(bf16x8, vw), pb, o[dt], 0, 0, 0);
                }
            }
        bf16_t* op = YCAT + (size_t)(tok0 + tql + r) * DM + 512 + hq * 64 + 4 * h;
#pragma unroll
        for (int dt = 0; dt < 2; ++dt)
#pragma unroll
            for (int g4 = 0; g4 < 4; ++g4) {
                u32x2 w; w.x = pk2(o[dt][4 * g4 + 0] * inv, o[dt][4 * g4 + 1] * inv); w.y = pk2(o[dt][4 * g4 + 2] * inv, o[dt][4 * g4 + 3] * inv);
                *(u32x2*)(op + 32 * dt + 8 * g4) = w;
            }
    }
    __syncthreads();
}

__device__ __forceinline__ void ssm_scan(LAS unsigned char* lds, const float* XLOC, bf16_t* UX, const float* a_re, const float* a_im, const float* log_dt, int g, int b, int tid) {
    const f32x4* src = (const f32x4*)(XLOC + ((size_t)g * 512 + b * 256) * 128);
    for (int i = tid; i < 256 * 128 / 4; i += 512) ((LAS f32x4*)lds)[i] = src[i];
    __syncthreads();
    if (tid < 64) {
        const int p = tid;
        const float dt = __expf(log_dt[g]);
        float ar, ai; apow(a_re[g * 64 + p], a_im[g * 64 + p], dt, 32.0f, ar, ai);
        float xr = 0.f, xi = 0.f;
        bf16_t* dst = UX + ((size_t)g * 512 + b * 256) * 640 + 512 + p;
        const LAS float* ls = (const LAS float*)lds;
#pragma unroll 8
        for (int j = 0; j < 256; ++j) {
            const unsigned w = pk2(xr, xi);
            dst[(size_t)j * 640] = (bf16_t)(w & 0xffffu); dst[(size_t)j * 640 + 64] = (bf16_t)(w >> 16);
            const float lr = ls[j * 128 + p], li = ls[j * 128 + 64 + p];
            const float nr = ar * xr - ai * xi + lr, ni = ar * xi + ai * xr + li;
            xr = nr; xi = ni;
        }
    }
    asm volatile("s_waitcnt vmcnt(0)" ::: "memory");
    __syncthreads();
}

__global__ void __launch_bounds__(512, 2) mega_fwd(Params P) {
    extern __shared__ __attribute__((aligned(16))) unsigned char lds_raw[];
    cg::grid_group grid = cg::this_grid();
    LAS unsigned char* const lds = (LAS unsigned char*)lds_raw;
    unsigned char* ws = P.ws;
    bf16_t* XB = (bf16_t*)(ws + WS_XB); bf16_t* YCAT = (bf16_t*)(ws + WS_YCAT); bf16_t* MERGED = (bf16_t*)(ws + WS_MERGED);
    bf16_t* HB = (bf16_t*)(ws + WS_UNION); bf16_t* PROJ = (bf16_t*)(ws + WS_UNION); float* VB = (float*)(ws + WS_UNION + UNION_V);
    bf16_t* UX = (bf16_t*)(ws + WS_UX); bf16_t* YPRE = (bf16_t*)(ws + WS_YPRE); float* XLOC = (float*)(ws + WS_XLOC);
    float* X = P.out;

    { const Ctx C = make_ctx(lds);
    for (int i = C.gtid; i < MTOK * DM / 4; i += C.NT) { const f32x4 v = ((const f32x4*)P.in[0])[i]; u32x2 w; w.x = pk2(v.x, v.y); w.y = pk2(v.z, v.w); ((u32x2*)XB)[i] = w; }
    prep_layer(P, 0, C); }
    grid.sync();

    for (int l = 0; l < NLAYER; ++l) {
        const float* resid = (l == 0) ? P.in[0] : X;
        { pg8::Sched S = pg8::make_sched(XB, DM, ws + WS_WGU1, DM, 64, 22, DM); pg8::EpiFfnUp E{HB}; pg8::gemm_phase(lds, DM, DM, S, E); }
        grid.sync();
        { pg8::Sched S = pg8::make_sched(HB, DFF, ws + WS_WD1, DFF, 64, 4, DFF); pg8::EpiResid E{resid, VB, 0.5f}; pg8::gemm_phase(lds, DFF, DFF, S, E); }
        grid.sync();
        { const Ctx C = make_ctx(lds); ln_pass(VB, P.in[4] + l * DM, P.in[5] + l * DM, X, XB, C); }
        grid.sync();
        { pg8::Sched S = pg8::make_sched(XB, DM, ws + WS_WIN, DM, 64, 19, DM); pg8::EpiWin E{PROJ, UX}; pg8::gemm_phase(lds, DM, DM, S, E); }
        grid.sync();
        for (int u = blockIdx.x; u < 256; u += gridDim.x) attn_unit(lds, PROJ, YCAT, P.in[18] + l * 8, u, opaque_tid());
        { const Ctx C = make_ctx(lds); conv_pass(PROJ, P.in[7] + l * 768, P.in[8] + l * 256, YCAT, C); }
        { pg8::Sched S = pg8::make_sched(UX, 640, ws + WS_E, 512, 2, 1, 512); S.nZ = 16; S.a_z = (size_t)512 * 640 * 2; S.b_z = (size_t)128 * 512 * 2;
          pg8::EpiSsm1 E{XLOC}; pg8::gemm_phase(lds, 640, 512, S, E); }
        grid.sync();
        { pg8::Sched S = pg8::make_sched(UX, 640, ws + WS_TF, 640, 2, 2, 640); S.nZ = 16; S.a_z = (size_t)512 * 640 * 2; S.b_z = (size_t)512 * 640 * 2;
          pg8::GUnit u0;
          if (S.next(0, u0)) ssm_scan(lds, XLOC, UX, P.in[9] + l * 1024, P.in[10] + l * 1024, P.in[11] + l * 16, u0.z, u0.pm, opaque_tid());
          pg8::EpiSsm2 E{UX, P.in[16] + l * 256, YPRE}; pg8::gemm_phase(lds, 640, 640, S, E); }
        grid.sync();
        { pg8::Sched S = pg8::make_sched(YPRE, 256, ws + WS_WGLU, 256, 64, 1, 256); pg8::EpiGlu E{YPRE, YCAT}; pg8::gemm_phase(lds, 256, 256, S, E); }
        grid.sync();
        { pg8::Sched S = pg8::make_sched(YCAT, DM, ws + WS_WBR, DM, 64, 4, DM); S.nseg = 3; S.k0pack = (4u << 8) | (8u << 16); S.ntpack = 4u | (4u << 8) | (8u << 16);
          pg8::EpiBranch E{PROJ, MERGED}; pg8::gemm_phase(lds, DM, DM, S, E); }
        grid.sync();
        { pg8::Sched S = pg8::make_sched(MERGED, DM, ws + WS_WOUT, DM, 64, 4, DM); pg8::EpiResid E{X, VB, 1.0f}; pg8::gemm_phase(lds, DM, DM, S, E); }
        grid.sync();
        { const Ctx C = make_ctx(lds); ln_pass(VB, P.in[23] + l * DM, P.in[24] + l * DM, X, XB, C); }
        grid.sync();
        { pg8::Sched S = pg8::make_sched(XB, DM, ws + WS_WGU2, DM, 64, 22, DM); pg8::EpiFfnUp E{HB}; pg8::gemm_phase(lds, DM, DM, S, E); }
        grid.sync();
        { pg8::Sched S = pg8::make_sched(HB, DFF, ws + WS_WD2, DFF, 64, 4, DFF); pg8::EpiResid E{X, VB, 0.5f}; pg8::gemm_phase(lds, DFF, DFF, S, E); }
        grid.sync();
        { const Ctx C = make_ctx(lds); ln_pass(VB, P.in[28] + l * DM, P.in[29] + l * DM, X, XB, C);
          if (l + 1 < NLAYER) prep_layer(P, l + 1, C); }
        if (l + 1 < NLAYER) grid.sync();
    }
}

extern "C" void kernel_launch(void* const* d_in, const int* in_sizes, int n_in, void* d_out, int out_size, void* d_ws, size_t ws_size, hipStream_t stream) {
    static int grid = 0;
    if (grid == 0) {
        if (n_in != 30 || out_size != MTOK * DM || ws_size < WS_END) { fprintf(stderr, "kernel_launch: unexpected problem (n_in %d out %d ws %zu)\n", n_in, out_size, ws_size); grid = -1; return; }
        int dev = 0, cus = 0, per_cu = 0;
        (void)hipGetDevice(&dev);
        (void)hipDeviceGetAttribute(&cus, hipDeviceAttributeMultiprocessorCount, dev);
        if (hipFuncSetAttribute((const void*)mega_fwd, hipFuncAttributeMaxDynamicSharedMemorySize, LDS_BYTES) != hipSuccess) { fprintf(stderr, "kernel_launch: hipFuncSetAttribute failed\n"); grid = -1; return; }
        if (hipOccupancyMaxActiveBlocksPerMultiprocessor(&per_cu, (const void*)mega_fwd, 512, LDS_BYTES) != hipSuccess || per_cu < 1) { fprintf(stderr, "kernel_launch: occupancy query says %d\n", per_cu); per_cu = 1; }
        (void)hipGetLastError();
        grid = cus * 1;
        if (grid <= 0) grid = 256;
    }
    if (grid < 0) return;
    Params p{};
    for (int i = 0; i < 30; ++i) p.in[i] = (const float*)d_in[i];
    p.out = (float*)d_out; p.ws = (unsigned char*)d_ws;
    void* args[] = {&p};
    hipError_t e = hipLaunchCooperativeKernel((const void*)mega_fwd, dim3(grid), dim3(512), args, LDS_BYTES, stream);
    if (e != hipSuccess) fprintf(stderr, "cooperative launch failed: %s (grid %d)\n", hipGetErrorString(e), grid);
}
```
